# Optimizing an MI355X kernel written in HIP

```python
import jax, jax.numpy as jnp
from jax import lax
import numpy as np

D_MODEL = 1024
BATCH = 4
SEQ = 4096
DEPTH = 2
DEC_BATCH = 128
DEC_SEQ = 4
PAST_LEN = 16384
PAGE_SIZE = 128

F32 = jnp.float32
HEAD_DIM = 64
ROT_DIM = HEAD_DIM // 4
ROPE_THETA = 500000.0
BLOCK = 128
A_Q_HEADS = 8
A_KV_HEADS = 2
A_GROUP = A_Q_HEADS // A_KV_HEADS
A_WINDOW = 128
B_DILATIONS = ((128, 1), (512, 4), (2048, 16))
N_B_GROUPS = 3
B_Q_HEADS = 8
B_KV_HEADS = 2
B_GROUP = B_Q_HEADS // B_KV_HEADS
A_QW = A_Q_HEADS * HEAD_DIM
A_KW = A_KV_HEADS * HEAD_DIM
B_QW = N_B_GROUPS * B_Q_HEADS * HEAD_DIM
B_KW = N_B_GROUPS * B_KV_HEADS * HEAD_DIM
MIX0 = A_QW + B_Q_HEADS * HEAD_DIM
IN0 = A_QW + 2 * A_KW + B_QW + 2 * B_KW + MIX0
C_HEADS = 4
C_HEAD_DIM = 256
MIX1 = C_HEADS * C_HEAD_DIM
IN1 = 5 * MIX1 + 2 * C_HEADS
CHUNK = 128
DN_ALPHA = (2 * DEPTH) ** 0.25
DN_BETA = (8 * DEPTH) ** -0.25
LN_EPS = 1e-5
MH_EPS = 1e-6
NEG_INF = -1e30
N_EVEN = (DEPTH + 1) // 2
N_ODD = DEPTH // 2

kernel_name = 'hybrid_swa_dilated_mlstm_deepnorm_step'


def layer_norm(x, g, b):
    xf = x.astype(F32)
    mu = xf.mean(-1, keepdims=True)
    var = jnp.square(xf - mu).mean(-1, keepdims=True)
    return ((xf - mu) * lax.rsqrt(var + LN_EPS) * g.astype(F32) + b.astype(F32)).astype(x.dtype)


def rope_partial(x, pos):
    half = ROT_DIM // 2
    inv = ROPE_THETA ** (-jnp.arange(half, dtype=F32) / half)
    ang = pos.astype(F32)[:, None] * inv[None, :]
    cos = jnp.cos(ang)[None, :, None, :]
    sin = jnp.sin(ang)[None, :, None, :]
    xr = x[..., :ROT_DIM].astype(F32)
    x1, x2 = xr[..., :half], xr[..., half:]
    rot = jnp.concatenate([x1 * cos - x2 * sin, x2 * cos + x1 * sin], axis=-1).astype(x.dtype)
    return jnp.concatenate([rot, x[..., ROT_DIM:]], axis=-1)


def _softmax_stats(s, mask, sink):
    s = jnp.where(mask, s, NEG_INF)
    m = s.max(-1)
    if sink is not None:
        m = jnp.maximum(m, sink)
    p = jnp.exp(s - m[..., None])
    den = p.sum(-1)
    if sink is not None:
        den = den + jnp.exp(sink - m)
    return p, den, m + jnp.log(den)


def banded_attention(q, k, v, span, sink=None):
    N, n = q.shape[0], q.shape[1]
    Hk, G, dh = q.shape[2], q.shape[3], q.shape[4]
    pad = (-n) % BLOCK
    if pad:
        q = jnp.pad(q, ((0, 0), (0, pad), (0, 0), (0, 0), (0, 0)))
        k = jnp.pad(k, ((0, 0), (0, pad), (0, 0), (0, 0)))
        v = jnp.pad(v, ((0, 0), (0, pad), (0, 0), (0, 0)))
    nb = (n + pad) // BLOCK
    qb = q.reshape(N, nb, BLOCK, Hk, G, dh)

    def with_prev(t):
        tb = t.reshape(N, nb, BLOCK, Hk, dh)
        prev = jnp.pad(tb, ((0, 0), (1, 0), (0, 0), (0, 0), (0, 0)))[:, :nb]
        return jnp.concatenate([prev, tb], axis=2)

    kk, vv = with_prev(k), with_prev(v)
    s = jnp.einsum('nbqhgd,nbkhd->nbhgqk', qb, kk, preferred_element_type=F32)
    qi = jnp.arange(BLOCK)[:, None] + BLOCK
    ki = jnp.arange(2 * BLOCK)[None, :]
    dist = qi - ki
    band = (dist >= 0) & (dist <= span)
    has_prev = (jnp.arange(nb)[:, None, None] > 0) | (ki[None] >= BLOCK)
    mask = (band[None] & has_prev)[None, :, None, None]
    sink_b = None if sink is None else sink.astype(F32)[None, None, :, :, None]
    p, den, lse = _softmax_stats(s, mask, sink_b)
    o = jnp.einsum('nbhgqk,nbkhd->nbqhgd', p, vv.astype(F32))
    o = o / jnp.moveaxis(den, -1, 2)[..., None]
    lse = jnp.moveaxis(lse, -1, 2)
    o = o.reshape(N, nb * BLOCK, Hk, G, dh)[:, :n]
    lse = lse.reshape(N, nb * BLOCK, Hk, G)[:, :n]
    return o, lse


def strided_gather_attention(q, k_all, v_all, n_past, span, dilation, sink=None):
    T = q.shape[1]
    idx = n_past + jnp.arange(T)[:, None] - dilation * jnp.arange(span + 1)[None, :]
    valid = idx >= 0
    idx = jnp.maximum(idx, 0)
    kg = k_all[:, idx]
    vg = v_all[:, idx]
    s = jnp.einsum('nthgd,ntjhd->nthgj', q, kg, preferred_element_type=F32)
    sink_b = None if sink is None else sink.astype(F32)[None, None]
    p, den, lse = _softmax_stats(s, valid[None, :, None, None, :], sink_b)
    o = jnp.einsum('nthgj,ntjhd->nthgd', p, vg.astype(F32)) / den[..., None]
    return o, lse


def _to_sub(t, dil):
    Bn, S = t.shape[0], t.shape[1]
    rest = t.shape[2:]
    return jnp.moveaxis(t.reshape((Bn, S // dil, dil) + rest), 2, 1).reshape((Bn * dil, S // dil) + rest)


def _from_sub(t, Bn, dil):
    n = t.shape[1]
    rest = t.shape[2:]
    return jnp.moveaxis(t.reshape((Bn, dil, n) + rest), 1, 2).reshape((Bn, n * dil) + rest)


def _layer0_project(x, pos, w_in):
    Bn, S, _ = x.shape
    h = jnp.einsum('bsd,de->bse', x, w_in)
    c1 = A_QW
    c2 = c1 + A_KW
    c3 = c2 + A_KW
    c4 = c3 + B_QW
    c5 = c4 + B_KW
    c6 = c5 + B_KW
    qa, ka, va, qb, kb, vb, z = jnp.split(h, [c1, c2, c3, c4, c5, c6], axis=-1)
    scale = HEAD_DIM ** -0.5
    qa = (rope_partial(qa.reshape(Bn, S, A_Q_HEADS, HEAD_DIM), pos) * scale).reshape(Bn, S, A_KV_HEADS, A_GROUP, HEAD_DIM)
    ka = rope_partial(ka.reshape(Bn, S, A_KV_HEADS, HEAD_DIM), pos)
    va = va.reshape(Bn, S, A_KV_HEADS, HEAD_DIM)
    qb = (rope_partial(qb.reshape(Bn, S, N_B_GROUPS * B_Q_HEADS, HEAD_DIM), pos) * scale).reshape(
        Bn, S, N_B_GROUPS, B_KV_HEADS, B_GROUP, HEAD_DIM)
    kb = rope_partial(kb.reshape(Bn, S, N_B_GROUPS * B_KV_HEADS, HEAD_DIM), pos).reshape(
        Bn, S, N_B_GROUPS, B_KV_HEADS, HEAD_DIM)
    vb = vb.reshape(Bn, S, N_B_GROUPS, B_KV_HEADS, HEAD_DIM)
    return qa, ka, va, qb, kb, vb, z


def _layer0_out(x, oa, obs, lses, z, w_out, ln_g, ln_b):
    Bn, S, _ = x.shape
    wts = jax.nn.softmax(jnp.stack(lses, axis=0), axis=0)
    ob = jnp.einsum('rbshg,rbshgd->bshgd', wts, jnp.stack(obs, axis=0))
    mix = jnp.concatenate([oa.reshape(Bn, S, A_QW), ob.reshape(Bn, S, MIX0 - A_QW)], axis=-1)
    mix = (mix * jax.nn.silu(z.astype(F32))).astype(x.dtype)
    y = jnp.einsum('bse,ed->bsd', mix, w_out)
    return layer_norm(DN_ALPHA * x + y, ln_g, ln_b)


def layer0_prompt(x, w_in, sinks, w_out, ln_g, ln_b):
    Bn, S, _ = x.shape
    pos = jnp.arange(S)
    qa, ka, va, qb, kb, vb, z = _layer0_project(x, pos, w_in)
    oa, _ = banded_attention(qa, ka, va, A_WINDOW, sinks.reshape(A_KV_HEADS, A_GROUP))
    la = min(A_WINDOW, S)
    a_state = jnp.stack([ka[:, S - la:], va[:, S - la:]], axis=2)
    obs, lses, b_states = [], [], []
    for g in range(N_B_GROUPS):
        win, dil = B_DILATIONS[g]
        o, lse = banded_attention(_to_sub(qb[:, :, g], dil), _to_sub(kb[:, :, g], dil),
                                  _to_sub(vb[:, :, g], dil), win // dil)
        obs.append(_from_sub(o, Bn, dil))
        lses.append(_from_sub(lse, Bn, dil))
        lg = min(win, S)
        b_states.append(jnp.stack([kb[:, S - lg:, g], vb[:, S - lg:, g]], axis=2))
    y = _layer0_out(x, oa, obs, lses, z, w_out, ln_g, ln_b)
    return y, a_state, b_states


def layer0_sample(x, cache_a, caches_b, w_in, sinks, w_out, ln_g, ln_b):
    Bn, T, _ = x.shape
    pos = PAST_LEN + jnp.arange(T)
    qa, ka, va, qb, kb, vb, z = _layer0_project(x, pos, w_in)
    kv_a = jnp.concatenate([cache_a.astype(ka.dtype), jnp.stack([ka, va], axis=2)], axis=1)
    oa, _ = strided_gather_attention(qa, kv_a[:, :, 0], kv_a[:, :, 1], cache_a.shape[1], A_WINDOW, 1,
                                     sinks.reshape(A_KV_HEADS, A_GROUP))
    a_state = kv_a[:, T:]
    obs, lses, b_states = [], [], []
    for g in range(N_B_GROUPS):
        win, dil = B_DILATIONS[g]
        cache = caches_b[g]
        kv_b = jnp.concatenate([cache.astype(kb.dtype), jnp.stack([kb[:, :, g], vb[:, :, g]], axis=2)], axis=1)
        o, lse = strided_gather_attention(qb[:, :, g], kv_b[:, :, 0], kv_b[:, :, 1], cache.shape[1], win // dil, dil)
        obs.append(o)
        lses.append(lse)
        b_states.append(kv_b[:, T:])
    y = _layer0_out(x, oa, obs, lses, z, w_out, ln_g, ln_b)
    return y, a_state, b_states


def _layer1_project(x, w_in, b_gates):
    Bn, S, _ = x.shape
    h = jnp.einsum('bsd,de->bse', x, w_in)
    q, k, v, o, z, gates = jnp.split(h, [MIX1, 2 * MIX1, 3 * MIX1, 4 * MIX1, 5 * MIX1], axis=-1)
    gates = gates.astype(F32) + b_gates.astype(F32)
    ig = gates[..., :C_HEADS]
    lf = jax.nn.log_sigmoid(gates[..., C_HEADS:])
    q = q.reshape(Bn, S, C_HEADS, C_HEAD_DIM).astype(F32)
    k = k.reshape(Bn, S, C_HEADS, C_HEAD_DIM).astype(F32) * (C_HEAD_DIM ** -0.5)
    v = v.reshape(Bn, S, C_HEADS, C_HEAD_DIM).astype(F32)
    return q, k, v, ig, lf, o, z


def _mlstm_chunk(carry, inp):
    c_mem, c_norm, c_max = carry
    q, k, v, ig, lf = inp
    L = q.shape[1]
    b = jnp.cumsum(lf, axis=1)
    causal = jnp.tril(jnp.ones((L, L), dtype=bool))[None, :, :, None]
    dmat = jnp.where(causal, b[:, :, None, :] - b[:, None, :, :] + ig[:, None, :, :], NEG_INF)
    inter = b + c_max[:, None, :]
    m = jnp.maximum(inter, dmat.max(axis=2))
    pw = jnp.exp(dmat - m[:, :, None, :])
    sc = jnp.einsum('bthd,bshd->btsh', q, k) * pw
    carry_w = jnp.exp(inter - m)
    num = jnp.einsum('btsh,bshd->bthd', sc, v) + carry_w[..., None] * jnp.einsum('bthk,bhkv->bthv', q, c_mem)
    den = sc.sum(axis=2) + carry_w * jnp.einsum('bthk,bhk->bth', q, c_norm)
    h = num / jnp.maximum(jnp.abs(den), jnp.exp(-m))[..., None]
    m_new = m[:, -1]
    ws = jnp.exp(b[:, -1:, :] - b + ig - m_new[:, None, :])
    decay = jnp.exp(b[:, -1] + c_max - m_new)
    c_mem_new = decay[..., None, None] * c_mem + jnp.einsum('bsh,bshk,bshv->bhkv', ws, k, v)
    c_norm_new = decay[..., None] * c_norm + jnp.einsum('bsh,bshk->bhk', ws, k)
    return (c_mem_new, c_norm_new, m_new), h


def _chunks(t):
    return jnp.moveaxis(t.reshape((t.shape[0], t.shape[1] // CHUNK, CHUNK) + t.shape[2:]), 1, 0)


def _layer1_out(x, h, o, z, mh_g, w_out, ln_g, ln_b):
    Bn, S, _ = x.shape
    h = jax.nn.sigmoid(o.astype(F32)).reshape(Bn, S, C_HEADS, C_HEAD_DIM) * h
    mu = h.mean(-1, keepdims=True)
    var = jnp.square(h - mu).mean(-1, keepdims=True)
    hn = ((h - mu) * lax.rsqrt(var + MH_EPS)).reshape(Bn, S, MIX1) * mh_g.astype(F32)
    mix = (hn * jax.nn.silu(z.astype(F32))).astype(x.dtype)
    y = jnp.einsum('bse,ed->bsd', mix, w_out)
    return layer_norm(DN_ALPHA * x + y, ln_g, ln_b)


def layer1_prompt(x, w_in, b_gates, mh_g, w_out, ln_g, ln_b):
    Bn, S, _ = x.shape
    q, k, v, ig, lf, o, z = _layer1_project(x, w_in, b_gates)
    init = (jnp.zeros((Bn, C_HEADS, C_HEAD_DIM, C_HEAD_DIM), F32),
            jnp.zeros((Bn, C_HEADS, C_HEAD_DIM), F32),
            jnp.zeros((Bn, C_HEADS), F32))
    state, h = lax.scan(_mlstm_chunk, init, (_chunks(q), _chunks(k), _chunks(v), _chunks(ig), _chunks(lf)))
    h = jnp.moveaxis(h, 0, 1).reshape(Bn, S, C_HEADS, C_HEAD_DIM)
    y = _layer1_out(x, h, o, z, mh_g, w_out, ln_g, ln_b)
    return y, state


def layer1_sample(x, c_mem, c_norm, c_max, w_in, b_gates, mh_g, w_out, ln_g, ln_b):
    q, k, v, ig, lf, o, z = _layer1_project(x, w_in, b_gates)
    state, h = _mlstm_chunk((c_mem.astype(F32), c_norm.astype(F32), c_max.astype(F32)), (q, k, v, ig, lf))
    y = _layer1_out(x, h, o, z, mh_g, w_out, ln_g, ln_b)
    return y, state


def setup_inputs(seed: int = 0) -> dict:
    key = jax.random.key(seed)
    ks = jax.random.split(key, 20)
    nrm = jax.random.normal
    x_prompt = nrm(ks[0], (BATCH, SEQ, D_MODEL), F32)
    x_sample = nrm(ks[1], (DEC_BATCH, DEC_SEQ, D_MODEL), F32)
    cache_a_kv = nrm(ks[2], (N_EVEN, DEC_BATCH, min(A_WINDOW, PAST_LEN), 2, A_KV_HEADS, HEAD_DIM), F32)
    cache_b0_kv = nrm(ks[3], (N_EVEN, DEC_BATCH, min(B_DILATIONS[0][0], PAST_LEN), 2, B_KV_HEADS, HEAD_DIM), F32)
    cache_b1_kv = nrm(ks[4], (N_EVEN, DEC_BATCH, min(B_DILATIONS[1][0], PAST_LEN), 2, B_KV_HEADS, HEAD_DIM), F32)
    cache_b2_kv = nrm(ks[5], (N_EVEN, DEC_BATCH, min(B_DILATIONS[2][0], PAST_LEN), 2, B_KV_HEADS, HEAD_DIM), F32)
    state_c_mem = 0.05 * nrm(ks[6], (N_ODD, DEC_BATCH, C_HEADS, C_HEAD_DIM, C_HEAD_DIM), F32)
    state_c_norm = 0.2 * nrm(ks[7], (N_ODD, DEC_BATCH, C_HEADS, C_HEAD_DIM), F32)
    state_c_max = nrm(ks[8], (N_ODD, DEC_BATCH, C_HEADS), F32)
    col0 = np.ones((IN0,), np.float32)
    va0 = A_QW + A_KW
    col0[va0:va0 + A_KW] = DN_BETA
    vb0 = A_QW + 2 * A_KW + B_QW + B_KW
    col0[vb0:vb0 + B_KW] = DN_BETA
    w_in0 = nrm(ks[9], (N_EVEN, D_MODEL, IN0), F32) * (D_MODEL ** -0.5) * jnp.asarray(col0)
    sinks0 = 0.5 * nrm(ks[10], (N_EVEN, A_Q_HEADS), F32)
    w_out0 = nrm(ks[11], (N_EVEN, MIX0, D_MODEL), F32) * (MIX0 ** -0.5 * DN_BETA)
    col1 = np.ones((IN1,), np.float32)
    col1[2 * MIX1:3 * MIX1] = DN_BETA
    w_in1 = nrm(ks[12], (N_ODD, D_MODEL, IN1), F32) * (D_MODEL ** -0.5) * jnp.asarray(col1)
    ig_bias = 0.1 * nrm(ks[13], (N_ODD, C_HEADS), F32)
    fg_bias = jnp.linspace(3.0, 6.0, C_HEADS, dtype=F32)[None] + 0.01 * nrm(ks[14], (N_ODD, C_HEADS), F32)
    b_gates1 = jnp.concatenate([ig_bias, fg_bias], axis=-1)
    mh_norm1 = 1.0 + 0.02 * nrm(ks[15], (N_ODD, MIX1), F32)
    w_out1 = nrm(ks[16], (N_ODD, MIX1, D_MODEL), F32) * (MIX1 ** -0.5 * DN_BETA)
    ln_g = 1.0 + 0.02 * nrm(ks[17], (DEPTH, D_MODEL), F32)
    ln_b = 0.02 * nrm(ks[18], (DEPTH, D_MODEL), F32)
    return {'x_prompt': x_prompt, 'x_sample': x_sample,
            'cache_a_kv': cache_a_kv, 'cache_b0_kv': cache_b0_kv, 'cache_b1_kv': cache_b1_kv,
            'cache_b2_kv': cache_b2_kv, 'state_c_mem': state_c_mem, 'state_c_norm': state_c_norm,
            'state_c_max': state_c_max, 'w_in0': w_in0, 'sinks0': sinks0, 'w_out0': w_out0,
            'w_in1': w_in1, 'b_gates1': b_gates1, 'mh_norm1': mh_norm1, 'w_out1': w_out1,
            'ln_g': ln_g, 'ln_b': ln_b}


def reference(x_prompt, x_sample, cache_a_kv, cache_b0_kv, cache_b1_kv, cache_b2_kv, state_c_mem,
              state_c_norm, state_c_max, w_in0, sinks0, w_out0, w_in1, b_gates1, mh_norm1, w_out1,
              ln_g, ln_b):
    yp, ys = x_prompt, x_sample
    ap, bp, cp = [], [[], [], []], [[], [], []]
    asm, bsm, csm = [], [[], [], []], [[], [], []]
    for layer in range(DEPTH):
        e = layer // 2
        if layer % 2 == 0:
            yp, a_new, b_new = layer0_prompt(yp, w_in0[e], sinks0[e], w_out0[e], ln_g[layer], ln_b[layer])
            ap.append(a_new)
            for g in range(N_B_GROUPS):
                bp[g].append(b_new[g])
            ys, a_new, b_new = layer0_sample(ys, cache_a_kv[e], (cache_b0_kv[e], cache_b1_kv[e], cache_b2_kv[e]),
                                             w_in0[e], sinks0[e], w_out0[e], ln_g[layer], ln_b[layer])
            asm.append(a_new)
            for g in range(N_B_GROUPS):
                bsm[g].append(b_new[g])
        else:
            yp, c_new = layer1_prompt(yp, w_in1[e], b_gates1[e], mh_norm1[e], w_out1[e], ln_g[layer], ln_b[layer])
            for i in range(3):
                cp[i].append(c_new[i])
            ys, c_new = layer1_sample(ys, state_c_mem[e], state_c_norm[e], state_c_max[e], w_in1[e], b_gates1[e],
                                      mh_norm1[e], w_out1[e], ln_g[layer], ln_b[layer])
            for i in range(3):
                csm[i].append(c_new[i])
    return (yp, ys,
            jnp.stack(ap, 0), jnp.stack(bp[0], 0), jnp.stack(bp[1], 0), jnp.stack(bp[2], 0),
            jnp.stack(cp[0], 0), jnp.stack(cp[1], 0), jnp.stack(cp[2], 0),
            jnp.stack(asm, 0), jnp.stack(bsm[0], 0), jnp.stack(bsm[1], 0), jnp.stack(bsm[2], 0),
            jnp.stack(csm[0], 0), jnp.stack(csm[1], 0), jnp.stack(csm[2], 0))
```

```cpp
#include <hip/hip_runtime.h>
#include <cstdint>
#include <cmath>

constexpr int DM = 1024, NB = 4, SEQ = 4096, NS = 128, TS = 4, PAST = 16384;
constexpr int MP = NB * SEQ;
constexpr int MS = NS * TS;
constexpr int M = MP + MS;
constexpr int IN0 = 4096, IN1 = 5128;
constexpr int C_QA = 0, C_KA = 512, C_VA = 640, C_QB = 768, C_KB = 2304, C_VB = 2688, C_Z0 = 3072;
constexpr int C1_Q = 0, C1_K = 1024, C1_V = 2048, C1_O = 3072, C1_Z = 4096, C1_G = 5120;
constexpr float DN_ALPHA = 1.4142135623730951f;
constexpr float LN_EPS = 1e-5f, MH_EPS = 1e-6f;

constexpr size_t O_YP = 0;
constexpr size_t O_YS = O_YP + (size_t)MP * DM;
constexpr size_t O_AKP = O_YS + (size_t)MS * DM;
constexpr size_t O_B0P = O_AKP + (size_t)NB * 128 * 256;
constexpr size_t O_B1P = O_B0P + (size_t)NB * 128 * 256;
constexpr size_t O_B2P = O_B1P + (size_t)NB * 512 * 256;
constexpr size_t O_CMP = O_B2P + (size_t)NB * 2048 * 256;
constexpr size_t O_CNP = O_CMP + (size_t)NB * 4 * 65536;
constexpr size_t O_CXP = O_CNP + (size_t)NB * 4 * 256;
constexpr size_t O_AKS = O_CXP + (size_t)NB * 4;
constexpr size_t O_B0S = O_AKS + (size_t)NS * 128 * 256;
constexpr size_t O_B1S = O_B0S + (size_t)NS * 128 * 256;
constexpr size_t O_B2S = O_B1S + (size_t)NS * 512 * 256;
constexpr size_t O_CMS = O_B2S + (size_t)NS * 2048 * 256;
constexpr size_t O_CNS = O_CMS + (size_t)NS * 4 * 65536;
constexpr size_t O_CXS = O_CNS + (size_t)NS * 4 * 256;
constexpr size_t O_END = O_CXS + (size_t)NS * 4;

constexpr size_t MiB = 1ull << 20;
constexpr size_t WS_X = 0;
constexpr size_t WS_BIG = 66 * MiB;
constexpr size_t WS_MIX = 400 * MiB;
constexpr size_t WS_Y = 466 * MiB;
constexpr size_t WS_X1 = 532 * MiB;
constexpr size_t WS_HRAW = 598 * MiB;
constexpr size_t WS_ROPE = 664 * MiB;

__device__ __forceinline__ float wave_sum(float v) {
#pragma unroll
    for (int o = 1; o < 64; o <<= 1) v += __shfl_xor(v, o);
    return v;
}
__device__ __forceinline__ float sigmoidf_(float x) { return 1.f / (1.f + expf(-x)); }
__device__ __forceinline__ float siluf_(float x) { return x * sigmoidf_(x); }
__device__ __forceinline__ float logsigmoidf_(float x) { return fminf(x, 0.f) - log1pf(expf(-fabsf(x))); }

__global__ __launch_bounds__(256) void sgemm_nn(const float* __restrict__ A, const float* __restrict__ B, float* __restrict__ C,
                                                int Mr, int N, int K, int lda, int ldb, int ldc) {
    __shared__ float As[16][68];
    __shared__ float Bs[16][68];
    const int tid = threadIdx.x, tx = tid & 15, ty = tid >> 4;
    const int m0 = blockIdx.y * 64, n0 = blockIdx.x * 64;
    float acc[4][4];
#pragma unroll
    for (int i = 0; i < 4; ++i)
#pragma unroll
        for (int j = 0; j < 4; ++j) acc[i][j] = 0.f;
    for (int k0 = 0; k0 < K; k0 += 16) {
        {
            const int r = tid >> 2, kq = (tid & 3) * 4;
            const float4 a = *(const float4*)(A + (size_t)(m0 + r) * lda + k0 + kq);
            As[kq + 0][r] = a.x; As[kq + 1][r] = a.y; As[kq + 2][r] = a.z; As[kq + 3][r] = a.w;
        }
        {
            const int kr = tid >> 4, c = (tid & 15) * 4;
            float4 b = make_float4(0.f, 0.f, 0.f, 0.f);
            if (n0 + c < N) b = *(const float4*)(B + (size_t)(k0 + kr) * ldb + n0 + c);
            Bs[kr][c + 0] = b.x; Bs[kr][c + 1] = b.y; Bs[kr][c + 2] = b.z; Bs[kr][c + 3] = b.w;
        }
        __syncthreads();
#pragma unroll
        for (int kk = 0; kk < 16; ++kk) {
            float a[4], b[4];
#pragma unroll
            for (int i = 0; i < 4; ++i) a[i] = As[kk][ty * 4 + i];
#pragma unroll
            for (int j = 0; j < 4; ++j) b[j] = Bs[kk][tx * 4 + j];
#pragma unroll
            for (int i = 0; i < 4; ++i)
#pragma unroll
                for (int j = 0; j < 4; ++j) acc[i][j] = fmaf(a[i], b[j], acc[i][j]);
        }
        __syncthreads();
    }
#pragma unroll
    for (int i = 0; i < 4; ++i) {
        const int r = m0 + ty * 4 + i;
        const int c = n0 + tx * 4;
        if (r < Mr && c < N) *(float4*)(C + (size_t)r * ldc + c) = make_float4(acc[i][0], acc[i][1], acc[i][2], acc[i][3]);
    }
}

__global__ void rope_table(float* tab) {
    const int idx = blockIdx.x * blockDim.x + threadIdx.x;
    if (idx >= 4100 * 8) return;
    const int p = idx >> 3, i = idx & 7;
    const double pos = (p < 4096) ? (double)p : (double)(PAST + (p - 4096));
    const double inv = pow(500000.0, -(double)i / 8.0);
    const double ang = pos * inv;
    tab[p * 16 + i] = (float)cos(ang);
    tab[p * 16 + 8 + i] = (float)sin(ang);
}

__global__ void rope_apply(float* H, const float* tab) {
    const size_t idx = (size_t)blockIdx.x * blockDim.x + threadIdx.x;
    if (idx >= (size_t)M * 40 * 8) return;
    const int i = (int)(idx & 7);
    const int slot = (int)((idx >> 3) % 40);
    const int m = (int)(idx / 320);
    int base;
    if (slot < 8) base = C_QA + slot * 64;
    else if (slot < 10) base = C_KA + (slot - 8) * 64;
    else if (slot < 34) base = C_QB + (slot - 10) * 64;
    else base = C_KB + (slot - 34) * 64;
    const int p = (m < MP) ? (m & (SEQ - 1)) : (4096 + ((m - MP) & 3));
    const float c = tab[p * 16 + i], s = tab[p * 16 + 8 + i];
    float* h = H + (size_t)m * IN0 + base;
    const float x1 = h[i], x2 = h[i + 8];
    h[i] = x1 * c - x2 * s;
    h[i + 8] = x2 * c + x1 * s;
}

__global__ void kv_outputs(const float* __restrict__ H, const float* __restrict__ ca, const float* __restrict__ cb0,
                           const float* __restrict__ cb1, const float* __restrict__ cb2, float* __restrict__ out) {
    const size_t total = O_CMP - O_AKP + (O_CMS - O_AKS);
    for (size_t e = (size_t)blockIdx.x * blockDim.x + threadIdx.x; e < total; e += (size_t)gridDim.x * blockDim.x) {
        const bool prompt = e < (O_CMP - O_AKP);
        size_t o = prompt ? (O_AKP + e) : (O_AKS + (e - (O_CMP - O_AKP)));
        int kind; size_t rel; int R;
        if (prompt) {
            if (o < O_B0P) { kind = 0; rel = o - O_AKP; R = 128; }
            else if (o < O_B1P) { kind = 1; rel = o - O_B0P; R = 128; }
            else if (o < O_B2P) { kind = 2; rel = o - O_B1P; R = 512; }
            else { kind = 3; rel = o - O_B2P; R = 2048; }
        } else {
            if (o < O_B0S) { kind = 0; rel = o - O_AKS; R = 128; }
            else if (o < O_B1S) { kind = 1; rel = o - O_B0S; R = 128; }
            else if (o < O_B2S) { kind = 2; rel = o - O_B1S; R = 512; }
            else { kind = 3; rel = o - O_B2S; R = 2048; }
        }
        const int d = (int)(rel & 63), hk = (int)((rel >> 6) & 1), kv = (int)((rel >> 7) & 1);
        const size_t rowi = rel >> 8;
        const int r = (int)(rowi % R), bn = (int)(rowi / R);
        int col;
        if (kind == 0) col = (kv == 0 ? C_KA : C_VA) + hk * 64 + d;
        else col = (kv == 0 ? C_KB : C_VB) + (kind - 1) * 128 + hk * 64 + d;
        float v;
        if (prompt) {
            const int t = SEQ - R + r;
            v = H[(size_t)(bn * SEQ + t) * IN0 + col];
        } else {
            if (r < R - TS) {
                const float* c = kind == 0 ? ca : kind == 1 ? cb0 : kind == 2 ? cb1 : cb2;
                v = c[((size_t)bn * R + (r + TS)) * 256 + kv * 128 + hk * 64 + d];
            } else {
                const int i = r - (R - TS);
                v = H[(size_t)(MP + bn * TS + i) * IN0 + col];
            }
        }
        out[o] = v;
    }
}

__global__ __launch_bounds__(256) void attn_naive(const float* __restrict__ H, const float* __restrict__ ca, const float* __restrict__ cb0,
                                                  const float* __restrict__ cb1, const float* __restrict__ cb2,
                                                  const float* __restrict__ sinks, float* __restrict__ MIX) {
    const int lane = threadIdx.x & 63;
    const size_t wv = (size_t)blockIdx.x * 4 + (threadIdx.x >> 6);
    if (wv >= (size_t)M * 16) return;
    const int hs = (int)(wv & 15), m = (int)(wv >> 4);
    const bool isA = hs < 8;
    const int hq = isA ? hs : hs - 8, hk = hq >> 2;
    float mx = -1e30f, l = 0.f, acc = 0.f;
    const bool prompt = m < MP;
    const int b = prompt ? m / SEQ : (m - MP) / TS;
    const int t = prompt ? (m & (SEQ - 1)) : ((m - MP) & 3);
    const int ng = isA ? 1 : 3;
    for (int g = 0; g < ng; ++g) {
        int dil, R, qcol, kcol, vcol; const float* cache;
        if (isA) { dil = 1; R = 128; qcol = C_QA + hq * 64; kcol = C_KA + hk * 64; vcol = C_VA + hk * 64; cache = ca; }
        else {
            dil = g == 0 ? 1 : g == 1 ? 4 : 16; R = g == 0 ? 128 : g == 1 ? 512 : 2048;
            qcol = C_QB + g * 512 + hq * 64; kcol = C_KB + g * 128 + hk * 64; vcol = C_VB + g * 128 + hk * 64;
            cache = g == 0 ? cb0 : g == 1 ? cb1 : cb2;
        }
        const float q = H[(size_t)m * IN0 + qcol + lane] * 0.125f;
        for (int j = 0; j <= 128; ++j) {
            float kx, vx;
            if (prompt) {
                const int tk = t - j * dil;
                if (tk < 0) break;
                const float* row = H + (size_t)(b * SEQ + tk) * IN0;
                kx = row[kcol + lane]; vx = row[vcol + lane];
            } else {
                const int idx = R + t - j * dil;
                if (idx >= R) { const float* row = H + (size_t)(MP + b * TS + (idx - R)) * IN0; kx = row[kcol + lane]; vx = row[vcol + lane]; }
                else { const float* row = cache + ((size_t)b * R + idx) * 256; kx = row[hk * 64 + lane]; vx = row[128 + hk * 64 + lane]; }
            }
            const float s = wave_sum(q * kx);
            const float mn = fmaxf(mx, s);
            const float f = expf(mx - mn), p = expf(s - mn);
            l = l * f + p; acc = acc * f + p * vx; mx = mn;
        }
    }
    float o;
    if (isA) {
        const float sk = sinks[hq];
        const float mf = fmaxf(mx, sk);
        const float f = expf(mx - mf);
        const float den = l * f + expf(sk - mf);
        o = acc * f / den;
    } else o = acc / l;
    const float z = H[(size_t)m * IN0 + C_Z0 + hs * 64 + lane];
    MIX[(size_t)m * DM + hs * 64 + lane] = o * siluf_(z);
}

__global__ __launch_bounds__(256) void ln_rows(const float* __restrict__ X, const float* __restrict__ Y, const float* __restrict__ g,
                                               const float* __restrict__ bb, float* __restrict__ out0, float* __restrict__ out1, int split) {
    __shared__ float red[8];
    const int m = blockIdx.x, tid = threadIdx.x;
    const float4 x = *(const float4*)(X + (size_t)m * DM + tid * 4);
    const float4 y = *(const float4*)(Y + (size_t)m * DM + tid * 4);
    float v[4] = {DN_ALPHA * x.x + y.x, DN_ALPHA * x.y + y.y, DN_ALPHA * x.z + y.z, DN_ALPHA * x.w + y.w};
    float s = wave_sum(v[0] + v[1] + v[2] + v[3]);
    if ((tid & 63) == 0) red[tid >> 6] = s;
    __syncthreads();
    const float mean = (red[0] + red[1] + red[2] + red[3]) * (1.f / DM);
    float q = 0.f;
#pragma unroll
    for (int i = 0; i < 4; ++i) { v[i] -= mean; q += v[i] * v[i]; }
    q = wave_sum(q);
    if ((tid & 63) == 0) red[4 + (tid >> 6)] = q;
    __syncthreads();
    const float rstd = 1.f / sqrtf((red[4] + red[5] + red[6] + red[7]) * (1.f / DM) + LN_EPS);
    const float4 gg = *(const float4*)(g + tid * 4), be = *(const float4*)(bb + tid * 4);
    float4 o = make_float4(v[0] * rstd * gg.x + be.x, v[1] * rstd * gg.y + be.y, v[2] * rstd * gg.z + be.z, v[3] * rstd * gg.w + be.w);
    float* dst = (m < split) ? out0 + (size_t)m * DM : out1 + (size_t)(m - split) * DM;
    *(float4*)(dst + tid * 4) = o;
}

__global__ __launch_bounds__(1024) void mlstm_naive(const float* __restrict__ H1, const float* __restrict__ bg, const float* __restrict__ cmem_in,
                                                    const float* __restrict__ cnorm_in, const float* __restrict__ cmax_in,
                                                    float* __restrict__ Hraw, float* __restrict__ out) {
    __shared__ float qs[256], ks[256], red[4][256], dred[4];
    const int tid = threadIdx.x, j = tid & 255, g4 = tid >> 8;
    const bool prompt = blockIdx.x < 16;
    int h, row0, steps; float* cm_out; float* cn_out; float* cx_out;
    float C[64]; float nreg = 0.f; float mprev = 0.f;
    if (prompt) {
        const int b = blockIdx.x >> 2; h = blockIdx.x & 3; row0 = b * SEQ; steps = SEQ;
        cm_out = out + O_CMP + (size_t)(b * 4 + h) * 65536; cn_out = out + O_CNP + (b * 4 + h) * 256; cx_out = out + O_CXP + (b * 4 + h);
#pragma unroll
        for (int i = 0; i < 64; ++i) C[i] = 0.f;
    } else {
        const int s = blockIdx.x - 16; const int n = s >> 2; h = s & 3; row0 = MP + n * TS; steps = TS;
        cm_out = out + O_CMS + (size_t)(n * 4 + h) * 65536; cn_out = out + O_CNS + (n * 4 + h) * 256; cx_out = out + O_CXS + (n * 4 + h);
        const float* ci = cmem_in + (size_t)(n * 4 + h) * 65536;
#pragma unroll
        for (int i = 0; i < 64; ++i) C[i] = ci[(size_t)(g4 * 64 + i) * 256 + j];
        if (tid < 256) nreg = cnorm_in[(n * 4 + h) * 256 + tid];
        mprev = cmax_in[n * 4 + h];
    }
    const float big = bg[h], bfg = bg[4 + h];
    for (int st = 0; st < steps; ++st) {
        const float* row = H1 + (size_t)(row0 + st) * IN1;
        if (tid < 256) qs[tid] = row[C1_Q + h * 256 + tid];
        else if (tid < 512) ks[tid - 256] = row[C1_K + h * 256 + (tid - 256)] * 0.0625f;
        const float vj = row[C1_V + h * 256 + j];
        const float ig = row[C1_G + h] + big;
        const float lf = logsigmoidf_(row[C1_G + 4 + h] + bfg);
        const float mnew = fmaxf(lf + mprev, ig);
        const float fd = expf(lf + mprev - mnew), idg = expf(ig - mnew);
        __syncthreads();
        float part = 0.f;
#pragma unroll
        for (int i = 0; i < 64; ++i) {
            C[i] = fd * C[i] + idg * ks[g4 * 64 + i] * vj;
            part = fmaf(qs[g4 * 64 + i], C[i], part);
        }
        red[g4][j] = part;
        if (tid < 256) {
            nreg = fd * nreg + idg * ks[tid];
            const float dp = wave_sum(qs[tid] * nreg);
            if ((tid & 63) == 0) dred[tid >> 6] = dp;
        }
        __syncthreads();
        if (tid < 256) {
            const float num = red[0][j] + red[1][j] + red[2][j] + red[3][j];
            const float den = dred[0] + dred[1] + dred[2] + dred[3];
            Hraw[(size_t)(row0 + st) * DM + h * 256 + j] = num / fmaxf(fabsf(den), expf(-mnew));
        }
        mprev = mnew;
        __syncthreads();
    }
#pragma unroll
    for (int i = 0; i < 64; ++i) cm_out[(size_t)(g4 * 64 + i) * 256 + j] = C[i];
    if (tid < 256) cn_out[tid] = nreg;
    if (tid == 0) *cx_out = mprev;
}

__global__ __launch_bounds__(256) void mlstm_out(const float* __restrict__ H1, const float* __restrict__ Hraw, const float* __restrict__ mhg, float* __restrict__ MIX) {
    const int lane = threadIdx.x & 63;
    const size_t wv = (size_t)blockIdx.x * 4 + (threadIdx.x >> 6);
    if (wv >= (size_t)M * 4) return;
    const int h = (int)(wv & 3), m = (int)(wv >> 2);
    const float* row = H1 + (size_t)m * IN1;
    float v[4];
#pragma unroll
    for (int i = 0; i < 4; ++i) { const int c = h * 256 + i * 64 + lane; v[i] = sigmoidf_(row[C1_O + c]) * Hraw[(size_t)m * DM + c]; }
    const float mean = wave_sum(v[0] + v[1] + v[2] + v[3]) * (1.f / 256.f);
    float q = 0.f;
#pragma unroll
    for (int i = 0; i < 4; ++i) { v[i] -= mean; q += v[i] * v[i]; }
    const float rstd = 1.f / sqrtf(wave_sum(q) * (1.f / 256.f) + MH_EPS);
#pragma unroll
    for (int i = 0; i < 4; ++i) { const int c = h * 256 + i * 64 + lane; MIX[(size_t)m * DM + c] = v[i] * rstd * mhg[c] * siluf_(row[C1_Z + c]); }
}

extern "C" void kernel_launch(void* const* d_in, const int* in_sizes, int n_in, void* d_out, int out_size, void* d_ws, size_t ws_size, hipStream_t stream) {
    const float* x_prompt = (const float*)d_in[0];
    const float* x_sample = (const float*)d_in[1];
    const float* cache_a = (const float*)d_in[2];
    const float* cache_b0 = (const float*)d_in[3];
    const float* cache_b1 = (const float*)d_in[4];
    const float* cache_b2 = (const float*)d_in[5];
    const float* st_cmem = (const float*)d_in[6];
    const float* st_cnorm = (const float*)d_in[7];
    const float* st_cmax = (const float*)d_in[8];
    const float* w_in0 = (const float*)d_in[9];
    const float* sinks0 = (const float*)d_in[10];
    const float* w_out0 = (const float*)d_in[11];
    const float* w_in1 = (const float*)d_in[12];
    const float* b_gates1 = (const float*)d_in[13];
    const float* mh_norm1 = (const float*)d_in[14];
    const float* w_out1 = (const float*)d_in[15];
    const float* ln_g = (const float*)d_in[16];
    const float* ln_b = (const float*)d_in[17];
    float* out = (float*)d_out;
    char* ws = (char*)d_ws;
    float* Xc = (float*)(ws + WS_X); float* BIG = (float*)(ws + WS_BIG); float* MIXb = (float*)(ws + WS_MIX);
    float* Yb = (float*)(ws + WS_Y); float* X1 = (float*)(ws + WS_X1); float* HRAW = (float*)(ws + WS_HRAW); float* ROPE = (float*)(ws + WS_ROPE);

    (void)hipMemcpyAsync(Xc, x_prompt, (size_t)MP * DM * 4, hipMemcpyDeviceToDevice, stream);
    (void)hipMemcpyAsync(Xc + (size_t)MP * DM, x_sample, (size_t)MS * DM * 4, hipMemcpyDeviceToDevice, stream);
    rope_table<<<(4100 * 8 + 255) / 256, 256, 0, stream>>>(ROPE);
    sgemm_nn<<<dim3(IN0 / 64, M / 64), 256, 0, stream>>>(Xc, w_in0, BIG, M, IN0, DM, DM, IN0, IN0);
    rope_apply<<<(unsigned)(((size_t)M * 320 + 255) / 256), 256, 0, stream>>>(BIG, ROPE);
    kv_outputs<<<8192, 256, 0, stream>>>(BIG, cache_a, cache_b0, cache_b1, cache_b2, out);
    attn_naive<<<(unsigned)((size_t)M * 16 / 4), 256, 0, stream>>>(BIG, cache_a, cache_b0, cache_b1, cache_b2, sinks0, MIXb);
    sgemm_nn<<<dim3(DM / 64, M / 64), 256, 0, stream>>>(MIXb, w_out0, Yb, M, DM, DM, DM, DM, DM);
    ln_rows<<<M, 256, 0, stream>>>(Xc, Yb, ln_g, ln_b, X1, X1 + (size_t)MP * DM, MP);
    sgemm_nn<<<dim3((IN1 + 63) / 64, M / 64), 256, 0, stream>>>(X1, w_in1, BIG, M, IN1, DM, DM, IN1, IN1);
    mlstm_naive<<<16 + NS * 4, 1024, 0, stream>>>(BIG, b_gates1, st_cmem, st_cnorm, st_cmax, HRAW, out);
    mlstm_out<<<(unsigned)((size_t)M * 4 / 4), 256, 0, stream>>>(BIG, HRAW, mh_norm1, MIXb);
    sgemm_nn<<<dim3(DM / 64, M / 64), 256, 0, stream>>>(MIXb, w_out1, Yb, M, DM, DM, DM, DM, DM);
    ln_rows<<<M, 256, 0, stream>>>(X1, Yb, ln_g + DM, ln_b + DM, out + O_YP, out + O_YS, MP);
}
```
